# Optimizing an MI355X kernel written in HIP

```python
import jax, jax.numpy as jnp
from jax import lax
import numpy as np

D_MODEL = 2048
BATCH = 8
SEQ = 2048
DEPTH = 2

BRANCH_WIDTH = D_MODEL // 2
N_BRANCH = 4
SSD_HEAD_DIM = 64
SSD_HEADS = BRANCH_WIDTH // SSD_HEAD_DIM
SSD_GROUPS = 4
SSD_STATE = 128
SSD_CONV = 4
SSD_CHUNK = 128
SSD_XBC = BRANCH_WIDTH + 2 * SSD_GROUPS * SSD_STATE
ATTN_HEAD_DIM = 64
ATTN_Q_HEADS = BRANCH_WIDTH // ATTN_HEAD_DIM
ATTN_KV_HEADS = 4
KV_WIDTH = ATTN_KV_HEADS * ATTN_HEAD_DIM
WINDOW = 128
ROPE_THETA = 10000.0
SCONV_WIDTH = 3
LRU_WIDTH = BRANCH_WIDTH
LRU_BLOCKS = 16
LRU_BLOCK_DIM = LRU_WIDTH // LRU_BLOCKS
LRU_CONV = 4
LRU_C = 8.0
LN_EPS = 1e-5
RMS_EPS = 1e-5
DEEPNORM_ALPHA = (2.0 * DEPTH) ** 0.25
DEEPNORM_BETA = (8.0 * DEPTH) ** -0.25
ADA_INIT = 0.5

COL_SIZES = (
    BRANCH_WIDTH, SSD_XBC, SSD_HEADS,
    BRANCH_WIDTH, KV_WIDTH, KV_WIDTH, BRANCH_WIDTH,
    BRANCH_WIDTH, BRANCH_WIDTH, BRANCH_WIDTH, BRANCH_WIDTH,
    LRU_WIDTH, LRU_WIDTH,
    N_BRANCH * D_MODEL,
)
IN_COLS = sum(COL_SIZES)
SPLIT_POINTS = tuple(sum(COL_SIZES[:i + 1]) for i in range(len(COL_SIZES) - 1))

kernel_name = "hybrid_gated_parallel_mixers_deepnorm_adaln"


def layer_norm(x, w, b):
    xf = x.astype(jnp.float32)
    mu = xf.mean(-1, keepdims=True)
    var = jnp.square(xf - mu).mean(-1, keepdims=True)
    y = (xf - mu) * lax.rsqrt(var + LN_EPS) * w.astype(jnp.float32) + b.astype(jnp.float32)
    return y.astype(x.dtype)


def rms_norm(x):
    xf = x.astype(jnp.float32)
    return xf * lax.rsqrt(jnp.square(xf).mean(-1, keepdims=True) + RMS_EPS)


def causal_dwconv(x, w, b=None):
    k = w.shape[0]
    y = lax.conv_general_dilated(
        x, w[:, None, :].astype(x.dtype), window_strides=(1,), padding=[(k - 1, 0)],
        dimension_numbers=('NWC', 'WIO', 'NWC'), feature_group_count=x.shape[-1])
    return y if b is None else y + b.astype(x.dtype)


def rope(x, pos):
    half = x.shape[-1] // 2
    inv_freq = ROPE_THETA ** (-jnp.arange(half, dtype=jnp.float32) / half)
    ang = pos.astype(jnp.float32)[..., None] * inv_freq
    cos, sin = jnp.cos(ang)[:, :, None, :], jnp.sin(ang)[:, :, None, :]
    xf = x.astype(jnp.float32)
    x1, x2 = xf[..., :half], xf[..., half:]
    return jnp.concatenate([x1 * cos - x2 * sin, x2 * cos + x1 * sin], -1).astype(x.dtype)


def ssd_branch(z, xbc, dt, conv_w, conv_b, dt_bias, a_log, d_skip, norm_w):
    f32 = jnp.float32
    b, l, _ = z.shape
    nc, q, g, r = l // SSD_CHUNK, SSD_CHUNK, SSD_GROUPS, SSD_HEADS // SSD_GROUPS
    xbc = jax.nn.silu(causal_dwconv(xbc, conv_w, conv_b))
    xs, bm, cm = jnp.split(xbc, [BRANCH_WIDTH, BRANCH_WIDTH + SSD_GROUPS * SSD_STATE], axis=-1)
    xs = xs.astype(f32).reshape(b, l, SSD_HEADS, SSD_HEAD_DIM)
    dt = jax.nn.softplus(dt.astype(f32) + dt_bias.astype(f32))
    a = -jnp.exp(a_log.astype(f32))
    xdt = (xs * dt[..., None]).reshape(b, nc, q, g, r, SSD_HEAD_DIM)
    da = (dt * a).reshape(b, nc, q, g, r)
    bm = bm.astype(f32).reshape(b, nc, q, g, SSD_STATE)
    cm = cm.astype(f32).reshape(b, nc, q, g, SSD_STATE)
    cum = jnp.cumsum(da, axis=2)
    causal = jnp.tril(jnp.ones((q, q), bool))[None, None, :, :, None, None]
    seg = cum[:, :, :, None] - cum[:, :, None, :]
    decay = jnp.exp(jnp.where(causal, seg, -jnp.inf))
    cb = jnp.einsum('bclgn,bcsgn->bclsg', cm, bm)
    y_diag = jnp.einsum('bclsg,bclsgr,bcsgrp->bclgrp', cb, decay, xdt)
    decay_to_end = jnp.exp(cum[:, :, -1:] - cum)
    states = jnp.einsum('bcsgn,bcsgr,bcsgrp->bcgrpn', bm, decay_to_end, xdt)
    chunk_decay = jnp.exp(cum[:, :, -1])

    def step(h, inp):
        s, dcy = inp
        return h * dcy[..., None, None] + s, h

    h0 = jnp.zeros((b, g, r, SSD_HEAD_DIM, SSD_STATE), f32)
    _, prev = lax.scan(step, h0, (jnp.moveaxis(states, 1, 0), jnp.moveaxis(chunk_decay, 1, 0)))
    prev = jnp.moveaxis(prev, 0, 1)
    y_off = jnp.einsum('bclgn,bcgrpn,bclgr->bclgrp', cm, prev, jnp.exp(cum))
    y = (y_diag + y_off).reshape(b, l, SSD_HEADS, SSD_HEAD_DIM) + xs * d_skip.astype(f32)[:, None]
    y = y.reshape(b, l, BRANCH_WIDTH) * jax.nn.silu(z.astype(f32))
    return (rms_norm(y) * norm_w.astype(f32)).astype(z.dtype)


def swa_branch(q, k, v, gate, pos, sinks):
    f32 = jnp.float32
    b, l, _ = q.shape
    nb, r = l // WINDOW, ATTN_Q_HEADS // ATTN_KV_HEADS
    q = rope(q.reshape(b, l, ATTN_Q_HEADS, ATTN_HEAD_DIM), pos)
    k = rope(k.reshape(b, l, ATTN_KV_HEADS, ATTN_HEAD_DIM), pos)
    v = v.reshape(b, l, ATTN_KV_HEADS, ATTN_HEAD_DIM)
    qb = q.reshape(b, nb, WINDOW, ATTN_KV_HEADS, r, ATTN_HEAD_DIM)

    def with_prev(t):
        tb = t.reshape(b, nb, WINDOW, ATTN_KV_HEADS, ATTN_HEAD_DIM)
        prev = jnp.pad(tb, ((0, 0), (1, 0), (0, 0), (0, 0), (0, 0)))[:, :-1]
        return jnp.concatenate([prev, tb], axis=2)

    kb, vb = with_prev(k), with_prev(v)
    s = jnp.einsum('bnqkrd,bnskd->bnkrqs', qb, kb).astype(f32) * (ATTN_HEAD_DIM ** -0.5)
    qi = jnp.arange(WINDOW)[:, None]
    sj = jnp.arange(2 * WINDOW)[None, :]
    rel = qi + WINDOW - sj
    band = (rel >= 0) & (rel < WINDOW)
    blk = jnp.arange(nb)[:, None, None]
    valid = band[None] & ((blk > 0) | (sj[None] >= WINDOW))
    s = jnp.where(valid[None, :, None, None], s, -jnp.inf)
    sink = sinks.astype(f32).reshape(ATTN_KV_HEADS, r)[None, None, :, :, None, None]
    m = jnp.maximum(s.max(-1, keepdims=True), sink)
    e = jnp.exp(s - m)
    p = e / (e.sum(-1, keepdims=True) + jnp.exp(sink - m))
    o = jnp.einsum('bnkrqs,bnskd->bnqkrd', p.astype(vb.dtype), vb).reshape(b, l, BRANCH_WIDTH)
    return o * jax.nn.silu(gate)


def shortconv_branch(bg, cg, xs, gate, conv_w):
    return bg * causal_dwconv(cg * xs, conv_w) * jax.nn.silu(gate)


def rglru_branch(xs, gate, conv_w, conv_b, w_a, b_a, w_x, b_x, lam):
    f32 = jnp.float32
    b, l, _ = xs.shape
    xs = causal_dwconv(xs, conv_w, conv_b)
    xh = xs.reshape(b, l, LRU_BLOCKS, LRU_BLOCK_DIM)
    rg = jax.nn.sigmoid(jnp.einsum('blhi,hij->blhj', xh, w_a).reshape(b, l, LRU_WIDTH) + b_a)
    ig = jax.nn.sigmoid(jnp.einsum('blhi,hij->blhj', xh, w_x).reshape(b, l, LRU_WIDTH) + b_x)
    log_a = -LRU_C * rg.astype(f32) * jax.nn.softplus(-lam.astype(f32))
    a = jnp.exp(log_a)
    u = jnp.sqrt(-jnp.expm1(2.0 * log_a)) * (ig * xs).astype(f32)

    def combine(left, right):
        a1, b1 = left
        a2, b2 = right
        return a1 * a2, a2 * b1 + b2

    _, h = lax.associative_scan(combine, (a, u), axis=1)
    return (h * jax.nn.silu(gate.astype(f32))).astype(xs.dtype)


def hybrid_layer(x, pos, c_act, w_ada, b_ada, w_in, b_gate, ssd_conv_w, ssd_conv_b, ssd_dt_bias,
                 ssd_a_log, ssd_d, ssd_norm_w, attn_sinks, sconv_w, lru_conv_w, lru_conv_b,
                 lru_w_a, lru_b_a, lru_w_x, lru_b_x, lru_lambda, w_branch, w_out, ln_w, ln_b):
    b, l, d = x.shape
    ada = c_act @ w_ada + b_ada
    shift, scale, gate = jnp.split(ada, 3, axis=-1)
    h = x * (1 + scale[:, None]) + shift[:, None]
    proj = h @ w_in
    (a_z, a_xbc, a_dt, b_q, b_k, b_v, b_g, c_b, c_c, c_x, c_g, d_x, d_g, merge) = jnp.split(
        proj, SPLIT_POINTS, axis=-1)
    ys = (
        ssd_branch(a_z, a_xbc, a_dt, ssd_conv_w, ssd_conv_b, ssd_dt_bias, ssd_a_log, ssd_d, ssd_norm_w),
        swa_branch(b_q, b_k, b_v, b_g, pos, attn_sinks),
        shortconv_branch(c_b, c_c, c_x, c_g, sconv_w),
        rglru_branch(d_x, d_g, lru_conv_w, lru_conv_b, lru_w_a, lru_b_a, lru_w_x, lru_b_x, lru_lambda),
    )
    gates = jax.nn.sigmoid(merge.reshape(b, l, N_BRANCH, d) + b_gate)
    m = gates[:, :, 0] * (ys[0] @ w_branch[0])
    for i in range(1, N_BRANCH):
        m = m + gates[:, :, i] * (ys[i] @ w_branch[i])
    out = m @ w_out
    return layer_norm(DEEPNORM_ALPHA * x + gate[:, None] * out, ln_w, ln_b)


def setup_inputs(seed: int = 0) -> dict:
    key = jax.random.key(seed)
    ks = jax.random.split(key, 32)
    f32 = jnp.float32

    def nrm(k, shape, std):
        return std * jax.random.normal(k, shape, f32)

    dt0 = jnp.exp(jax.random.uniform(ks[8], (DEPTH, SSD_HEADS), f32, np.log(1e-3), np.log(1e-1)))
    a_pow = jax.random.uniform(ks[19], (DEPTH, LRU_WIDTH), f32, 0.9, 0.999)
    sig = a_pow ** (1.0 / LRU_C)
    offsets = jax.random.randint(ks[2], (BATCH, 1), 0, SEQ, jnp.int32)
    return {
        "x": nrm(ks[0], (BATCH, SEQ, D_MODEL), 1.0),
        "c": nrm(ks[1], (BATCH, D_MODEL), 1.0),
        "positions": offsets + jnp.arange(SEQ, dtype=jnp.int32)[None, :],
        "w_ada": nrm(ks[3], (DEPTH, D_MODEL, 3 * D_MODEL), ADA_INIT * D_MODEL ** -0.5),
        "b_ada": nrm(ks[4], (DEPTH, 3 * D_MODEL), 0.01),
        "w_in": nrm(ks[5], (DEPTH, D_MODEL, IN_COLS), D_MODEL ** -0.5),
        "b_gate": nrm(ks[6], (DEPTH, N_BRANCH, D_MODEL), 0.01),
        "ssd_conv_w": nrm(ks[7], (DEPTH, SSD_CONV, SSD_XBC), SSD_CONV ** -0.5),
        "ssd_conv_b": nrm(ks[9], (DEPTH, SSD_XBC), 0.01),
        "ssd_dt_bias": dt0 + jnp.log(-jnp.expm1(-dt0)),
        "ssd_a_log": jnp.log(jax.random.uniform(ks[10], (DEPTH, SSD_HEADS), f32, 1.0, 16.0)),
        "ssd_d": 1.0 + nrm(ks[11], (DEPTH, SSD_HEADS), 0.1),
        "ssd_norm_w": 1.0 + nrm(ks[12], (DEPTH, BRANCH_WIDTH), 0.1),
        "attn_sinks": nrm(ks[13], (DEPTH, ATTN_Q_HEADS), 1.0),
        "sconv_w": nrm(ks[14], (DEPTH, SCONV_WIDTH, BRANCH_WIDTH), SCONV_WIDTH ** -0.5),
        "lru_conv_w": nrm(ks[15], (DEPTH, LRU_CONV, LRU_WIDTH), LRU_CONV ** -0.5),
        "lru_conv_b": nrm(ks[16], (DEPTH, LRU_WIDTH), 0.01),
        "lru_w_a": nrm(ks[17], (DEPTH, LRU_BLOCKS, LRU_BLOCK_DIM, LRU_BLOCK_DIM), LRU_BLOCK_DIM ** -0.5),
        "lru_b_a": nrm(ks[18], (DEPTH, LRU_WIDTH), 0.01),
        "lru_w_x": nrm(ks[20], (DEPTH, LRU_BLOCKS, LRU_BLOCK_DIM, LRU_BLOCK_DIM), LRU_BLOCK_DIM ** -0.5),
        "lru_b_x": nrm(ks[21], (DEPTH, LRU_WIDTH), 0.01),
        "lru_lambda": jnp.log(sig) - jnp.log1p(-sig),
        "w_branch": nrm(ks[22], (DEPTH, N_BRANCH, BRANCH_WIDTH, D_MODEL), DEEPNORM_BETA * BRANCH_WIDTH ** -0.5),
        "w_out": nrm(ks[23], (DEPTH, D_MODEL, D_MODEL), DEEPNORM_BETA * D_MODEL ** -0.5),
        "ln_w": 1.0 + nrm(ks[24], (DEPTH, D_MODEL), 0.1),
        "ln_b": nrm(ks[25], (DEPTH, D_MODEL), 0.01),
    }


def reference(x, c, positions, w_ada, b_ada, w_in, b_gate, ssd_conv_w, ssd_conv_b, ssd_dt_bias,
              ssd_a_log, ssd_d, ssd_norm_w, attn_sinks, sconv_w, lru_conv_w, lru_conv_b, lru_w_a,
              lru_b_a, lru_w_x, lru_b_x, lru_lambda, w_branch, w_out, ln_w, ln_b):
    c_act = jax.nn.silu(c)
    for i in range(DEPTH):
        x = hybrid_layer(
            x, positions, c_act, w_ada[i], b_ada[i], w_in[i], b_gate[i], ssd_conv_w[i], ssd_conv_b[i],
            ssd_dt_bias[i], ssd_a_log[i], ssd_d[i], ssd_norm_w[i], attn_sinks[i], sconv_w[i],
            lru_conv_w[i], lru_conv_b[i], lru_w_a[i], lru_b_a[i], lru_w_x[i], lru_b_x[i], lru_lambda[i],
            w_branch[i], w_out[i], ln_w[i], ln_b[i])
    return x
```

```cpp
#include <hip/hip_runtime.h>
#include <hip/hip_cooperative_groups.h>
#include <cstdio>
#include <cstdint>
namespace cg = cooperative_groups;

#define LAS __attribute__((address_space(3)))
typedef unsigned short bf16_t;
typedef short bf16x8 __attribute__((ext_vector_type(8)));
typedef float f32x4 __attribute__((ext_vector_type(4)));
typedef float f32x2 __attribute__((ext_vector_type(2)));
typedef unsigned u32x4 __attribute__((ext_vector_type(4)));
typedef unsigned u32x2 __attribute__((ext_vector_type(2)));

constexpr int MTOK = 16384, DM = 2048, SEQ = 2048, NB = 8, BW = 1024;
constexpr int NIN = 19984, NPAD = 20224;
constexpr int OFF_AZ = 0, OFF_XBC = 1024, OFF_DT = 3072, OFF_Q = 3088, OFF_K = 4112, OFF_V = 4368, OFF_BG = 4624;
constexpr int OFF_CB = 5648, OFF_CC = 6672, OFF_CX = 7696, OFF_CG = 8720, OFF_DX = 9744, OFF_DG = 10768, OFF_MG = 11792;
constexpr float ALPHA = 1.4142135623730951f;
constexpr size_t MiB = 1u << 20;
constexpr size_t WS_ADA = 0;
constexpr size_t WS_ROPE = 1 * MiB;
constexpr size_t WS_SSQ = 5 * MiB;
constexpr size_t WS_WIN = 8 * MiB;
constexpr size_t WS_WB = 166 * MiB;
constexpr size_t WS_WO = 198 * MiB;
constexpr size_t WS_H = 214 * MiB;
constexpr size_t WS_PROJ = 278 * MiB;
constexpr size_t WS_Y = 910 * MiB;
constexpr size_t WS_MF = 1038 * MiB;
constexpr size_t WS_MB = 1166 * MiB;
constexpr size_t WS_END = 1230 * MiB;
constexpr int LDS_BYTES = 147456;
#ifndef PHM
#define PHM 0xffff
#endif
constexpr int NTHR = 512;

struct Params {
    const float* x; const float* c; const int* pos; const float* w_ada; const float* b_ada; const float* w_in; const float* b_gate;
    const float* ssd_conv_w; const float* ssd_conv_b; const float* ssd_dt_bias; const float* ssd_a_log; const float* ssd_d; const float* ssd_norm_w;
    const float* attn_sinks; const float* sconv_w; const float* lru_conv_w; const float* lru_conv_b; const float* lru_w_a; const float* lru_b_a;
    const float* lru_w_x; const float* lru_b_x; const float* lru_lambda; const float* w_branch; const float* w_out; const float* ln_w; const float* ln_b;
    float* out; unsigned char* ws;
};

__device__ __forceinline__ unsigned cvt_pk_bf16(float lo, float hi) { unsigned r; asm volatile("v_cvt_pk_bf16_f32 %0, %1, %2" : "=v"(r) : "v"(lo), "v"(hi)); return r; }
__device__ __forceinline__ bf16_t f2bf(float f) { return (bf16_t)(cvt_pk_bf16(f, 0.f) & 0xffffu); }
__device__ __forceinline__ float bf2f(bf16_t h) { return __uint_as_float((unsigned)h << 16); }
__device__ __forceinline__ float silu_f(float x) { return x / (1.f + __expf(-x)); }
__device__ __forceinline__ float sigm_f(float x) { return 1.f / (1.f + __expf(-x)); }
__device__ __forceinline__ void unpack2(unsigned v, float& a, float& b) { a = __uint_as_float(v << 16); b = __uint_as_float(v & 0xffff0000u); }
__device__ __forceinline__ void unpack8(u32x4 v, float* f) { unpack2(v.x, f[0], f[1]); unpack2(v.y, f[2], f[3]); unpack2(v.z, f[4], f[5]); unpack2(v.w, f[6], f[7]); }
__device__ __forceinline__ void unpack4(u32x2 v, float* f) { unpack2(v.x, f[0], f[1]); unpack2(v.y, f[2], f[3]); }
__device__ __forceinline__ u32x4 pack8u(const float* f) { u32x4 w; w.x = cvt_pk_bf16(f[0], f[1]); w.y = cvt_pk_bf16(f[2], f[3]); w.z = cvt_pk_bf16(f[4], f[5]); w.w = cvt_pk_bf16(f[6], f[7]); return w; }
__device__ __forceinline__ bf16x8 pack8(const float* f) { return __builtin_bit_cast(bf16x8, pack8u(f)); }
__device__ __forceinline__ f32x4 mfma16(bf16x8 a, bf16x8 b, f32x4 c) { return __builtin_amdgcn_mfma_f32_16x16x32_bf16(a, b, c, 0, 0, 0); }
__device__ __forceinline__ int opaque_tid() { int t = threadIdx.x; asm volatile("" : "+v"(t)); return t; }
__device__ __forceinline__ float wave_sum(float v) {
#pragma unroll
    for (int o = 1; o < 64; o <<= 1) v += __shfl_xor(v, o);
    return v;
}

namespace pg8 {
constexpr int BM = 256, BK = 64, HALF = 128, HTB = HALF * BK * 2, STAGE_BYTES = 8 * HTB, NXCD = 8, WGM = 8;
__host__ __device__ __forceinline__ int lds_byte(int r, int c) { const int st = (r >> 4) * 2 + (c >> 5), rr = r & 15, cc = c & 31, ob = rr * 64 + cc * 2; return st * 1024 + (ob ^ (((ob >> 9) & 1) << 5)); }
__host__ __device__ __forceinline__ void stage_rc(int b, int& R, int& C) { const int st = b / 1024, sb = b % 1024, swz = sb ^ (((sb >> 9) & 1) << 5); R = (st >> 1) * 16 + swz / 64; C = (st & 1) * 32 + (swz % 64) / 2; }
__host__ __device__ __forceinline__ int perm32(int rho) { const int n = rho >> 4, i = rho & 15; return 8 * (i >> 2) + 4 * n + (i & 3); }
struct Unit { int pm, pn; };
struct Gemm { const bf16_t* A; const bf16_t* Bt; int M, N, K; };
struct StaticOrder {
    int nM, nN, nwg, G, c;
    __host__ __device__ void init(int M, int N, int G_, int c_) { nM = M / BM; nN = N / BM; nwg = nM * nN; G = G_; c = c_; }
    __host__ __device__ bool next(int i, Unit& u) const {
        const long L = (long)i * G + c; if (L >= nwg) return false;
        int wgid = (int)L; { const int q = nwg / NXCD, r = nwg % NXCD, xcd = wgid % NXCD, off = wgid / NXCD; wgid = (xcd < r ? xcd * (q + 1) : r * (q + 1) + (xcd - r) * q) + off; }
        const int nig = WGM * nN, gid = wgid / nig, fm = gid * WGM, gsz = (nM - fm) < WGM ? (nM - fm) : WGM;
        u.pm = fm + ((wgid % nig) % gsz); u.pn = (wgid % nig) / gsz; return true;
    }
    __device__ __forceinline__ void a_ready(const Unit&) const {}
    __device__ __forceinline__ void done(const Unit&) const {}
};
struct MergeOrder {
    StaticOrder base;
    __device__ bool next(int i, Unit& u) const { Unit t; if (!base.next(i >> 2, t)) return false; const int k = i & 3; u.pm = k * 64 + t.pm; u.pn = k * 8 + t.pn; return true; }
    __device__ __forceinline__ void a_ready(const Unit&) const {}
    __device__ __forceinline__ void done(const Unit&) const {}
};

template <class Epi, class Sched, bool ALIGN_EPI = false, bool SP2 = false>
__device__ __forceinline__ void gemm_phase(LAS unsigned char* lds, const Gemm g, const Sched& S, const Epi& E) {
    const int tid = opaque_tid(), wid = __builtin_amdgcn_readfirstlane(tid >> 6), lane = tid & 63, wr = wid >> 2, wc = wid & 3, fr = lane & 15, fq = lane >> 4;
    const int K = g.K, nt = K / BK;
    unsigned voffA[2], voffB[2];
#pragma unroll
    for (int i = 0; i < 2; ++i) { int R, C; stage_rc(tid * 16 + i * 8192, R, C); const int Rb = Epi::PERM ? ((R & ~31) + perm32(R & 31)) : R;
        voffA[i] = (unsigned)(R * K + C) * 2u; voffB[i] = (unsigned)(Rb * K + C) * 2u; }
    const size_t kstep = (size_t)(BK * 2);
    const size_t hstep = (size_t)HALF * K * 2;
    const size_t tstep = 2 * hstep;
    const unsigned ldsw = (unsigned)wid * 1024u;
    const int aoff = lds_byte(wr * 64 + fr, fq * 8), boff = lds_byte(wc * 32 + fr, fq * 8);
#define PG8_SA(b, h) (((b) * 2 + (h)) * HTB)
#define PG8_SB(b, h) ((4 + (b) * 2 + (h)) * HTB)
#define PG8_STAGE(bufoff, gbase, voff) do { _Pragma("unroll") for (int _i = 0; _i < 2; ++_i) \
        __builtin_amdgcn_global_load_lds((const unsigned*)((const char*)(gbase) + (voff)[_i]), (LAS unsigned*)(lds + (bufoff) + ldsw + _i * 8192), 16, 0, 0); } while (0)
#define PG8_LDA(dst, b, h) do { _Pragma("unroll") for (int m = 0; m < 4; ++m) _Pragma("unroll") for (int k = 0; k < 2; ++k) dst[m][k] = *(const LAS bf16x8*)(lds + PG8_SA(b, h) + aoff + m * 2048 + k * 1024); } while (0)
#define PG8_LDB(dst, b, h) do { _Pragma("unroll") for (int n = 0; n < 2; ++n) _Pragma("unroll") for (int k = 0; k < 2; ++k) dst[n][k] = *(const LAS bf16x8*)(lds + PG8_SB(b, h) + boff + n * 2048 + k * 1024); } while (0)
#define PG8_MMA(ai, bj, At, Bt) do { __builtin_amdgcn_s_setprio(1); _Pragma("unroll") for (int m = 0; m < 4; ++m) _Pragma("unroll") for (int n = 0; n < 2; ++n) _Pragma("unroll") for (int k = 0; k < 2; ++k) \
        acc[ai][bj][m][n] = __builtin_amdgcn_mfma_f32_16x16x32_bf16(Bt[n][k], At[m][k], acc[ai][bj][m][n], 0, 0, 0); __builtin_amdgcn_s_setprio(0); } while (0)
#define PG8_WAIT_V(n) asm volatile("s_waitcnt vmcnt(" #n ")" ::: "memory")
#define PG8_WAIT_L(n) asm volatile("s_waitcnt lgkmcnt(" #n ")" ::: "memory")
#define PG8_BAR __builtin_amdgcn_s_barrier()
#define PG8_SCHED __builtin_amdgcn_sched_barrier(0)
    Unit cur, nxt; int ui = 0;
    if (!S.next(0, cur)) return;
    f32x4 acc[2][2][4][2];
#pragma unroll
    for (int a = 0; a < 2; ++a)
#pragma unroll
        for (int b = 0; b < 2; ++b)
#pragma unroll
            for (int m = 0; m < 4; ++m)
#pragma unroll
                for (int n = 0; n < 2; ++n) acc[a][b][m][n] = (f32x4){0.f, 0.f, 0.f, 0.f};
    bf16x8 At[4][2], B0[2][2], B1[2][2];
    const char* cA = (const char*)g.A + (size_t)cur.pm * tstep; const char* cB = (const char*)g.Bt + (size_t)cur.pn * tstep;
    S.a_ready(cur);
    if constexpr (SP2) {
        PG8_STAGE(PG8_SB(0, 0), cB, voffB); PG8_STAGE(PG8_SB(0, 1), cB + hstep, voffB); PG8_STAGE(PG8_SA(0, 0), cA, voffA); PG8_STAGE(PG8_SA(0, 1), cA + hstep, voffA);
        if (wr == 1) PG8_BAR;
        PG8_WAIT_V(2); PG8_BAR;
        PG8_STAGE(PG8_SB(1, 0), cB + kstep, voffB); PG8_STAGE(PG8_SA(1, 0), cA + kstep, voffA); PG8_STAGE(PG8_SB(1, 1), cB + hstep + kstep, voffB);
        PG8_WAIT_V(6); PG8_BAR;
    } else {
        PG8_STAGE(PG8_SB(0, 0), cB, voffB); PG8_STAGE(PG8_SA(0, 0), cA, voffA); PG8_STAGE(PG8_SB(0, 1), cB + hstep, voffB); PG8_STAGE(PG8_SA(0, 1), cA + hstep, voffA);
        if (wr == 1) PG8_BAR;
        PG8_WAIT_V(4); PG8_BAR;
        PG8_STAGE(PG8_SB(1, 0), cB + kstep, voffB); PG8_STAGE(PG8_SA(1, 0), cA + kstep, voffA); PG8_STAGE(PG8_SB(1, 1), cB + hstep + kstep, voffB);
        PG8_WAIT_V(6); PG8_BAR;
    }
    for (;;) {
        const bool has_next = S.next(ui + 1, nxt);
        const char* nA = has_next ? (const char*)g.A + (size_t)nxt.pm * tstep : cA; const char* nB = has_next ? (const char*)g.Bt + (size_t)nxt.pn * tstep : cB;
        for (int t = 0; t < nt; t += 2) {
            const bool last = (t == nt - 2);
            const char* a1 = cA + (size_t)(t + 1) * kstep;
            const char* a2 = last ? nA : cA + (size_t)(t + 2) * kstep; const char* b2 = last ? nB : cB + (size_t)(t + 2) * kstep;
            const char* a3 = a2 + kstep; const char* b3 = b2 + kstep;
            if (last && has_next) S.a_ready(nxt);
            if constexpr (SP2) {
            PG8_LDB(B0, 0, 0); PG8_LDB(B1, 0, 1); PG8_SCHED; PG8_LDA(At, 0, 0); PG8_STAGE(PG8_SA(1, 1), a1 + hstep, voffA);
            PG8_WAIT_V(8); PG8_WAIT_L(0); PG8_BAR; PG8_MMA(0, 0, At, B0); PG8_MMA(0, 1, At, B1); PG8_BAR; PG8_SCHED;
            PG8_LDA(At, 0, 1); PG8_STAGE(PG8_SB(0, 0), b2, voffB); PG8_STAGE(PG8_SB(0, 1), b2 + hstep, voffB); PG8_STAGE(PG8_SA(0, 0), a2, voffA);
            PG8_WAIT_V(8); PG8_WAIT_L(0); PG8_BAR; PG8_MMA(1, 0, At, B0); PG8_MMA(1, 1, At, B1); PG8_BAR; PG8_SCHED;
            PG8_LDB(B0, 1, 0); PG8_LDB(B1, 1, 1); PG8_SCHED; PG8_LDA(At, 1, 0); PG8_STAGE(PG8_SA(0, 1), a2 + hstep, voffA);
            PG8_WAIT_V(8); PG8_WAIT_L(0); PG8_BAR; PG8_MMA(0, 0, At, B0); PG8_MMA(0, 1, At, B1); PG8_BAR; PG8_SCHED;
            PG8_LDA(At, 1, 1); PG8_STAGE(PG8_SB(1, 0), b3, voffB); PG8_STAGE(PG8_SB(1, 1), b3 + hstep, voffB); PG8_STAGE(PG8_SA(1, 0), a3, voffA);
            PG8_WAIT_V(8); PG8_WAIT_L(0); PG8_BAR; PG8_MMA(1, 0, At, B0); PG8_MMA(1, 1, At, B1); PG8_BAR; PG8_SCHED;
            } else {
            PG8_LDB(B0, 0, 0); PG8_SCHED; PG8_LDA(At, 0, 0); PG8_STAGE(PG8_SA(1, 1), a1 + hstep, voffA);
            PG8_WAIT_L(8); PG8_BAR; PG8_WAIT_L(0); PG8_MMA(0, 0, At, B0); PG8_BAR; PG8_SCHED;
            PG8_LDB(B1, 0, 1); PG8_STAGE(PG8_SB(0, 0), b2, voffB);
            PG8_BAR; PG8_WAIT_L(0); PG8_MMA(0, 1, At, B1); PG8_BAR;
            PG8_LDA(At, 0, 1); PG8_STAGE(PG8_SA(0, 0), a2, voffA);
            PG8_BAR; PG8_WAIT_L(0); PG8_MMA(1, 0, At, B0); PG8_BAR; PG8_SCHED;
            PG8_STAGE(PG8_SB(0, 1), b2 + hstep, voffB);
            PG8_WAIT_V(6); PG8_BAR; PG8_MMA(1, 1, At, B1); PG8_BAR;
            PG8_LDB(B0, 1, 0); PG8_SCHED; PG8_LDA(At, 1, 0); PG8_STAGE(PG8_SA(0, 1), a2 + hstep, voffA);
            PG8_WAIT_L(8); PG8_BAR; PG8_WAIT_L(0); PG8_MMA(0, 0, At, B0); PG8_BAR; PG8_SCHED;
            PG8_LDB(B1, 1, 1); PG8_STAGE(PG8_SB(1, 0), b3, voffB);
            PG8_BAR; PG8_WAIT_L(0); PG8_MMA(0, 1, At, B1); PG8_BAR;
            PG8_LDA(At, 1, 1); PG8_STAGE(PG8_SA(1, 0), a3, voffA);
            PG8_BAR; PG8_WAIT_L(0); PG8_MMA(1, 0, At, B0); PG8_BAR; PG8_SCHED;
            PG8_STAGE(PG8_SB(1, 1), b3 + hstep, voffB);
            PG8_WAIT_V(6); PG8_BAR; PG8_MMA(1, 1, At, B1); PG8_BAR;
            }
        }
        if constexpr (ALIGN_EPI) { if (wr == 0) PG8_BAR; }
        E(acc, cur, wr, wc, fr, fq); S.done(cur);
        if (!has_next) break;
#pragma unroll
        for (int a = 0; a < 2; ++a)
#pragma unroll
            for (int b = 0; b < 2; ++b)
#pragma unroll
                for (int m = 0; m < 4; ++m)
#pragma unroll
                    for (int n = 0; n < 2; ++n) acc[a][b][m][n] = (f32x4){0.f, 0.f, 0.f, 0.f};
        cur = nxt; cA = nA; cB = nB; ++ui;
        if constexpr (ALIGN_EPI) { if (wr == 1) PG8_BAR; }
    }
    PG8_WAIT_V(0);
    if constexpr (!ALIGN_EPI) { if (wr == 0) PG8_BAR; }
    PG8_BAR;
#undef PG8_SA
#undef PG8_SB
#undef PG8_STAGE
#undef PG8_LDA
#undef PG8_LDB
#undef PG8_MMA
#undef PG8_WAIT_V
#undef PG8_WAIT_L
#undef PG8_BAR
#undef PG8_SCHED
}

struct EpiProj {
    static constexpr bool PERM = true;
    bf16_t* O;
    __device__ __forceinline__ void operator()(const f32x4 (&acc)[2][2][4][2], const Unit& u, int wr, int wc, int fr, int fq) const {
        const int row0 = u.pm * BM + wr * 64 + fr, col0 = u.pn * BM + wc * 32 + 8 * fq;
#pragma unroll
        for (int ai = 0; ai < 2; ++ai)
#pragma unroll
            for (int m = 0; m < 4; ++m) { bf16_t* rowp = O + (size_t)(row0 + ai * HALF + m * 16) * NPAD + col0;
#pragma unroll
                for (int bj = 0; bj < 2; ++bj) { const f32x4 v0 = acc[ai][bj][m][0], v1 = acc[ai][bj][m][1];
                    u32x4 w; w.x = cvt_pk_bf16(v0[0], v0[1]); w.y = cvt_pk_bf16(v0[2], v0[3]); w.z = cvt_pk_bf16(v1[0], v1[1]); w.w = cvt_pk_bf16(v1[2], v1[3]);
                    *(u32x4*)(rowp + bj * HALF) = w; } }
    }
};
struct EpiMerge {
    static constexpr bool PERM = true;
    const bf16_t* proj; const float* bgate; const float* ssq; float* mf; bf16_t* mb;
    __device__ __forceinline__ void operator()(const f32x4 (&acc)[2][2][4][2], const Unit& u, int wr, int wc, int fr, int fq) const {
        const int k = u.pm >> 6, pm = u.pm & 63, pn = u.pn & 7;
        const int row0 = pm * BM + wr * 64 + fr, col0 = pn * BM + wc * 32 + 8 * fq;
        f32x4 bg[2][2];
#pragma unroll
        for (int bj = 0; bj < 2; ++bj)
#pragma unroll
            for (int n = 0; n < 2; ++n) bg[bj][n] = *(const f32x4*)(bgate + k * DM + col0 + bj * HALF + 4 * n);
#pragma unroll
        for (int ai = 0; ai < 2; ++ai)
#pragma unroll
            for (int m = 0; m < 4; ++m) {
                const size_t row = (size_t)(row0 + ai * HALF + m * 16);
                float rs = 1.f;
                if (k == 0) { const f32x4* sp = (const f32x4*)(ssq + row * 16); const f32x4 s0 = sp[0], s1 = sp[1], s2 = sp[2], s3 = sp[3];
                    const float tot = ((s0[0] + s0[1]) + (s0[2] + s0[3])) + ((s1[0] + s1[1]) + (s1[2] + s1[3])) + ((s2[0] + s2[1]) + (s2[2] + s2[3])) + ((s3[0] + s3[1]) + (s3[2] + s3[3]));
                    rs = 1.f / sqrtf(tot * (1.f / 1024.f) + 1e-5f); }
#pragma unroll
                for (int bj = 0; bj < 2; ++bj) {
                    const int col = col0 + bj * HALF;
                    const u32x4 gl = *(const u32x4*)(proj + row * NPAD + OFF_MG + k * DM + col);
                    float lg[8]; unpack8(gl, lg);
                    f32x4 v0, v1;
#pragma unroll
                    for (int j = 0; j < 4; ++j) { v0[j] = sigm_f(lg[j] + bg[bj][0][j]) * acc[ai][bj][m][0][j] * rs; v1[j] = sigm_f(lg[4 + j] + bg[bj][1][j]) * acc[ai][bj][m][1][j] * rs; }
                    float* mp = mf + row * DM + col;
                    if (k == 0) { *(f32x4*)mp = v0; *(f32x4*)(mp + 4) = v1; }
                    else { v0 += *(const f32x4*)mp; v1 += *(const f32x4*)(mp + 4);
                        if (k < 3) { *(f32x4*)mp = v0; *(f32x4*)(mp + 4) = v1; }
                        else { u32x4 w; w.x = cvt_pk_bf16(v0[0], v0[1]); w.y = cvt_pk_bf16(v0[2], v0[3]); w.z = cvt_pk_bf16(v1[0], v1[1]); w.w = cvt_pk_bf16(v1[2], v1[3]);
                            *(u32x4*)(mb + row * DM + col) = w; } }
                }
            }
    }
};
struct EpiOut {
    static constexpr bool PERM = false;
    const float* xin; const float* gate; float* R;
    __device__ __forceinline__ void operator()(const f32x4 (&acc)[2][2][4][2], const Unit& u, int wr, int wc, int fr, int fq) const {
        const int row0 = u.pm * BM + wr * 64 + fr, col0 = u.pn * BM + wc * 32 + 4 * fq, b = u.pm >> 3;
        f32x4 gv[2][2];
#pragma unroll
        for (int bj = 0; bj < 2; ++bj)
#pragma unroll
            for (int n = 0; n < 2; ++n) gv[bj][n] = *(const f32x4*)(gate + b * 6144 + col0 + bj * HALF + n * 16);
#pragma unroll
        for (int ai = 0; ai < 2; ++ai)
#pragma unroll
            for (int m = 0; m < 4; ++m) { const size_t ro = (size_t)(row0 + ai * HALF + m * 16) * DM + col0;
#pragma unroll
                for (int bj = 0; bj < 2; ++bj)
#pragma unroll
                    for (int n = 0; n < 2; ++n) { const f32x4 xv = *(const f32x4*)(xin + ro + bj * HALF + n * 16);
                        *(f32x4*)(R + ro + bj * HALF + n * 16) = xv * ALPHA + gv[bj][n] * acc[ai][bj][m][n]; } }
    }
};
}

__device__ __forceinline__ void transpose_item(const float* W, int K, int Nsrc, int Nvalid, bf16_t* WT, int row_off, const float* kscale, LAS float* scr, int kb, int nb, int lane) {
    const int k0 = 64 * kb, n0 = 32 * nb;
    const int n = n0 + (lane & 31);
#pragma unroll 8
    for (int i = 0; i < 32; ++i) { const int kk = 2 * i + (lane >> 5); float v = (n < Nvalid) ? W[(size_t)(k0 + kk) * Nsrc + n] : 0.f; if (kscale) v *= kscale[k0 + kk]; scr[kk * 33 + (lane & 31)] = v; }
    const int c = lane & 7;
#pragma unroll
    for (int j = 0; j < 4; ++j) { const int nn = (lane >> 3) + 8 * j; const LAS float* s = scr + (8 * c) * 33 + nn;
        u32x4 o; o.x = cvt_pk_bf16(s[0 * 33], s[1 * 33]); o.y = cvt_pk_bf16(s[2 * 33], s[3 * 33]); o.z = cvt_pk_bf16(s[4 * 33], s[5 * 33]); o.w = cvt_pk_bf16(s[6 * 33], s[7 * 33]);
        *(u32x4*)(WT + (size_t)(row_off + n0 + nn) * K + k0 + 8 * c) = o; }
}

__device__ __forceinline__ void phase_prologue(const Params& p, LAS unsigned char* lds) {
    const int tid = opaque_tid(), lane = tid & 63, w = tid >> 6;
    float* ada = (float*)(p.ws + WS_ADA);
    {
        LAS float* cs = (LAS float*)lds;
        LAS float* red = cs + 8 * 2048;
        bool staged = false;
        for (int it = blockIdx.x; it < 192; it += gridDim.x) {
            if (!staged) { for (int i = tid; i < 8 * 2048; i += NTHR) cs[i] = silu_f(p.c[i]); __syncthreads(); staged = true; }
            const int l = it / 96, jb = it % 96, j = jb * 64 + lane;
            const float* W = p.w_ada + (size_t)l * 2048 * 6144 + j;
            float a0 = 0.f, a1 = 0.f, a2 = 0.f, a3 = 0.f, a4 = 0.f, a5 = 0.f, a6 = 0.f, a7 = 0.f;
            const int k0 = w * 256;
#pragma unroll 8
            for (int k = k0; k < k0 + 256; ++k) { const float wv = W[(size_t)k * 6144];
                a0 += cs[0 * 2048 + k] * wv; a1 += cs[1 * 2048 + k] * wv; a2 += cs[2 * 2048 + k] * wv; a3 += cs[3 * 2048 + k] * wv;
                a4 += cs[4 * 2048 + k] * wv; a5 += cs[5 * 2048 + k] * wv; a6 += cs[6 * 2048 + k] * wv; a7 += cs[7 * 2048 + k] * wv; }
            LAS float* rw = red + (w * 8) * 64 + lane;
            rw[0 * 64] = a0; rw[1 * 64] = a1; rw[2 * 64] = a2; rw[3 * 64] = a3; rw[4 * 64] = a4; rw[5 * 64] = a5; rw[6 * 64] = a6; rw[7 * 64] = a7;
            __syncthreads();
            { const int b = w; float s = p.b_ada[l * 6144 + j];
#pragma unroll
              for (int w2 = 0; w2 < 8; ++w2) s += red[(w2 * 8 + b) * 64 + lane];
              ada[(size_t)(l * 8 + b) * 6144 + j] = s; }
            __syncthreads();
        }
        __syncthreads();
    }
    {
        float2* rope = (float2*)(p.ws + WS_ROPE);
        for (int idx = blockIdx.x * NTHR + tid; idx < NB * SEQ * 32; idx += gridDim.x * NTHR) {
            const int i = idx & 31, bt = idx >> 5;
            const float inv = exp2f((float)i * (-13.287712379549449f / 32.f));
            const float ang = (float)p.pos[bt] * inv;
            double rev = (double)ang * 0.15915494309189535; rev -= __builtin_rint(rev);
            const float r = (float)rev;
            rope[idx] = make_float2(__builtin_amdgcn_cosf(r), __builtin_amdgcn_sinf(r));
        }
    }
    {
        LAS float* scr = (LAS float*)lds + w * (64 * 33);
        const int gw = blockIdx.x * 8 + w, NGW = gridDim.x * 8;
        constexpr int I_IN = 32 * 632, I_BR = 16 * 64, I_OUT = 32 * 64, I_L = I_IN + 4 * I_BR + I_OUT;
        for (int it = gw; it < 2 * I_L; it += NGW) {
            const int l = it / I_L; int r = it % I_L;
            if (r < I_IN) { transpose_item(p.w_in + (size_t)l * 2048 * NIN, 2048, NIN, NIN, (bf16_t*)(p.ws + WS_WIN) + (size_t)l * NPAD * 2048, 0, nullptr, scr, r / 632, r % 632, lane); continue; }
            r -= I_IN;
            if (r < 4 * I_BR) { const int k = r / I_BR, rr = r % I_BR;
                transpose_item(p.w_branch + (size_t)(l * 4 + k) * 1024 * 2048, 1024, 2048, 2048, (bf16_t*)(p.ws + WS_WB) + (size_t)l * 8192 * 1024, k * 2048, k == 0 ? p.ssd_norm_w + l * 1024 : nullptr, scr, rr / 64, rr % 64, lane); continue; }
            r -= 4 * I_BR;
            transpose_item(p.w_out + (size_t)l * 2048 * 2048, 2048, 2048, 2048, (bf16_t*)(p.ws + WS_WO) + (size_t)l * 2048 * 2048, 0, nullptr, scr, r / 64, r % 64, lane);
        }
    }
}

__device__ __forceinline__ void phase_h0(const Params& p) {
    const int tid = opaque_tid(), lane = tid & 63, gw = blockIdx.x * 8 + (tid >> 6), NGW = gridDim.x * 8;
    const float* ada = (const float*)(p.ws + WS_ADA);
    bf16_t* H = (bf16_t*)(p.ws + WS_H);
    for (int row = gw; row < MTOK; row += NGW) {
        const int b = row >> 11; const float* ab = ada + (size_t)b * 6144;
#pragma unroll
        for (int j = 0; j < 8; ++j) { const int col = 4 * lane + 256 * j;
            const f32x4 xv = *(const f32x4*)(p.x + (size_t)row * DM + col), sh = *(const f32x4*)(ab + col), sc = *(const f32x4*)(ab + 2048 + col);
            const f32x4 hv = xv * (sc + 1.f) + sh;
            u32x2 o; o.x = cvt_pk_bf16(hv[0], hv[1]); o.y = cvt_pk_bf16(hv[2], hv[3]);
            *(u32x2*)(H + (size_t)row * DM + col) = o; }
    }
}

__device__ __forceinline__ void phase_ln(const Params& p, int layer) {
    const int tid = opaque_tid(), lane = tid & 63, gw = blockIdx.x * 8 + (tid >> 6), NGW = gridDim.x * 8;
    const float* R = (const float*)(p.ws + WS_MF);
    const float* ada1 = (const float*)(p.ws + WS_ADA) + (size_t)8 * 6144;
    const float* lw = p.ln_w + layer * DM; const float* lb = p.ln_b + layer * DM;
    bf16_t* H = (bf16_t*)(p.ws + WS_H);
    for (int row = gw; row < MTOK; row += NGW) {
        f32x4 v[8]; float s = 0.f;
#pragma unroll
        for (int j = 0; j < 8; ++j) { v[j] = *(const f32x4*)(R + (size_t)row * DM + 4 * lane + 256 * j); s += (v[j][0] + v[j][1]) + (v[j][2] + v[j][3]); }
        const float mean = wave_sum(s) * (1.f / DM); float s2 = 0.f;
#pragma unroll
        for (int j = 0; j < 8; ++j) { v[j] = v[j] - mean; s2 += (v[j][0] * v[j][0] + v[j][1] * v[j][1]) + (v[j][2] * v[j][2] + v[j][3] * v[j][3]); }
        const float rstd = 1.f / sqrtf(wave_sum(s2) * (1.f / DM) + 1e-5f);
        const int b = row >> 11;
#pragma unroll
        for (int j = 0; j < 8; ++j) { const int col = 4 * lane + 256 * j;
            const f32x4 y = v[j] * rstd * *(const f32x4*)(lw + col) + *(const f32x4*)(lb + col);
            *(f32x4*)(p.out + (size_t)row * DM + col) = y;
            if (layer == 0) { const f32x4 sh = *(const f32x4*)(ada1 + (size_t)b * 6144 + col), sc = *(const f32x4*)(ada1 + (size_t)b * 6144 + 2048 + col);
                const f32x4 hv = y * (sc + 1.f) + sh; u32x2 o; o.x = cvt_pk_bf16(hv[0], hv[1]); o.y = cvt_pk_bf16(hv[2], hv[3]);
                *(u32x2*)(H + (size_t)row * DM + col) = o; } }
    }
}

template <int CWP>
__device__ __forceinline__ void conv4_8(const bf16_t* src, int ts, const LAS float* cw, float* out) {
    { const f32x4 b0 = *(const LAS f32x4*)(cw + 4 * CWP), b1 = *(const LAS f32x4*)(cw + 4 * CWP + 4);
#pragma unroll
      for (int j = 0; j < 4; ++j) { out[j] = b0[j]; out[4 + j] = b1[j]; } }
#pragma unroll
    for (int k = 0; k < 4; ++k) {
        const int d = k - 3;
        if (ts + d >= 0) {
            const u32x4 v = *(const u32x4*)(src + (long)d * NPAD); float f[8]; unpack8(v, f);
            const f32x4 w0 = *(const LAS f32x4*)(cw + k * CWP), w1 = *(const LAS f32x4*)(cw + k * CWP + 4);
#pragma unroll
            for (int j = 0; j < 4; ++j) { out[j] += w0[j] * f[j]; out[4 + j] += w1[j] * f[4 + j]; }
        }
    }
}

__device__ __forceinline__ void ssd_item(const Params& p, int layer, int item, LAS unsigned char* lds) {
    const int tid = opaque_tid(), lane = tid & 63, w = __builtin_amdgcn_readfirstlane(tid >> 6), fr = lane & 15, fq = lane >> 4;
    const int b = item >> 4, h = item & 15, g = h >> 2;
    constexpr int BP = 136;
    LAS bf16_t* Bs = (LAS bf16_t*)lds;
    LAS bf16_t* Bt = Bs + 128 * BP;
    LAS bf16_t* xt = Bt + 128 * BP;
    LAS bf16_t* xwt = xt + 64 * BP;
    LAS bf16_t* prv = xwt + 64 * BP;
    LAS float* cuml = (LAS float*)(prv + 64 * BP);
    LAS float* dtv = cuml + 128;
    LAS float* tot = dtv + 128;
    LAS float* cw = tot + 16;
    const bf16_t* proj = (const bf16_t*)(p.ws + WS_PROJ);
    bf16_t* Y0 = (bf16_t*)(p.ws + WS_Y);
    float* ssqo = (float*)(p.ws + WS_SSQ);
    __syncthreads();
    { const float* cvw = p.ssd_conv_w + (size_t)layer * 4 * 2048; const float* cvb = p.ssd_conv_b + layer * 2048;
      for (int i = tid; i < 5 * 320; i += NTHR) { const int k = i / 320, idx = i % 320;
          const int ch = idx < 64 ? h * 64 + idx : (idx < 192 ? 1024 + g * 128 + (idx - 64) : 1536 + g * 128 + (idx - 192));
          cw[i] = k < 4 ? cvw[k * 2048 + ch] : cvb[ch]; } }
    const float Ah = -__expf(p.ssd_a_log[layer * 16 + h]), dtb = p.ssd_dt_bias[layer * 16 + h], Dh = p.ssd_d[layer * 16 + h];
    f32x4 S[4];
#pragma unroll
    for (int i = 0; i < 4; ++i) S[i] = (f32x4){0.f, 0.f, 0.f, 0.f};
    __syncthreads();
    for (int c = 0; c < 16; ++c) {
        const int ts = c * 128 + w * 16 + fr;
        const size_t row = (size_t)b * SEQ + ts;
        const bf16_t* prow = proj + row * NPAD;
        { float da = 0.f, dtval = 0.f;
          if (lane < 16) { const float xx = bf2f(prow[OFF_DT + h]) + dtb; dtval = xx > 20.f ? xx : log1pf(__expf(xx)); da = dtval * Ah; }
          float cs = da;
#pragma unroll
          for (int o = 1; o < 16; o <<= 1) { const float v = __shfl_up(cs, o); if (fr >= o) cs += v; }
          if (lane < 16) { cuml[w * 16 + fr] = cs; dtv[w * 16 + fr] = dtval; if (fr == 15) tot[w] = cs; } }
#pragma unroll
        for (int ks = 0; ks < 4; ++ks) {
            const int n0 = ks * 32 + fq * 8; float f[8];
            conv4_8<320>(prow + OFF_XBC + 1024 + g * 128 + n0, ts, cw + 64 + n0, f);
#pragma unroll
            for (int j = 0; j < 8; ++j) f[j] = silu_f(f[j]);
            const u32x4 pk = pack8u(f);
            *(LAS u32x4*)(Bs + (w * 16 + fr) * BP + n0) = pk;
#pragma unroll
            for (int j = 0; j < 8; ++j) Bt[(n0 + j) * BP + w * 16 + fr] = (bf16_t)((j & 1) ? (pk[j >> 1] >> 16) : (pk[j >> 1] & 0xffffu));
        }
        bf16x8 Cf[4];
#pragma unroll
        for (int ks = 0; ks < 4; ++ks) {
            const int n0 = ks * 32 + fq * 8; float f[8];
            conv4_8<320>(prow + OFF_XBC + 1536 + g * 128 + n0, ts, cw + 192 + n0, f);
#pragma unroll
            for (int j = 0; j < 8; ++j) f[j] = silu_f(f[j]);
            Cf[ks] = pack8(f);
        }
        float xv[2][8];
#pragma unroll
        for (int ks = 0; ks < 2; ++ks) {
            const int p0 = ks * 32 + fq * 8;
            conv4_8<320>(prow + OFF_XBC + h * 64 + p0, ts, cw + p0, xv[ks]);
#pragma unroll
            for (int j = 0; j < 8; ++j) xv[ks][j] = silu_f(xv[ks][j]);
        }
#pragma unroll
        for (int pt = 0; pt < 4; ++pt)
#pragma unroll
            for (int r = 0; r < 4; ++r) prv[(pt * 16 + fq * 4 + r) * BP + w * 16 + fr] = f2bf(S[pt][r]);
        __syncthreads();
        float offs[8]; float run = 0.f;
#pragma unroll
        for (int i = 0; i < 8; ++i) { offs[i] = run; run += tot[i]; }
        const float total = run;
        float myoff = 0.f;
#pragma unroll
        for (int i = 0; i < 8; ++i) if (i == w) myoff = offs[i];
        const float cum_l = cuml[w * 16 + fr] + myoff;
        { const float wgt = dtv[w * 16 + fr] * __expf(total - cum_l);
#pragma unroll
          for (int ks = 0; ks < 2; ++ks)
#pragma unroll
              for (int j = 0; j < 8; ++j) { const int pp = ks * 32 + fq * 8 + j; xt[pp * BP + w * 16 + fr] = f2bf(xv[ks][j]); xwt[pp * BP + w * 16 + fr] = f2bf(xv[ks][j] * wgt); } }
        __syncthreads();
        f32x4 yacc[4], oacc[4];
#pragma unroll
        for (int i = 0; i < 4; ++i) { yacc[i] = (f32x4){0.f, 0.f, 0.f, 0.f}; oacc[i] = (f32x4){0.f, 0.f, 0.f, 0.f}; }
        const int lrow = w * 16 + fr;
#pragma unroll
        for (int pp = 0; pp < 4; ++pp) {
            if (2 * pp <= w) {
                float md[8];
#pragma unroll
                for (int hf = 0; hf < 2; ++hf) {
                    const int st = 2 * pp + hf;
                    if (st <= w) {
                        f32x4 a = (f32x4){0.f, 0.f, 0.f, 0.f};
#pragma unroll
                        for (int ks = 0; ks < 4; ++ks) { const bf16x8 bfr = *(const LAS bf16x8*)(Bs + (st * 16 + fr) * BP + ks * 32 + fq * 8); a = mfma16(bfr, Cf[ks], a); }
#pragma unroll
                        for (int r = 0; r < 4; ++r) { const int s = st * 16 + fq * 4 + r; const float cs = cuml[s] + offs[st];
                            float v = a[r] * __expf(cum_l - cs) * dtv[s]; v = (s <= lrow) ? v : 0.f; if (s == lrow) v += Dh; md[hf * 4 + r] = v; }
                    } else {
#pragma unroll
                        for (int r = 0; r < 4; ++r) md[hf * 4 + r] = 0.f;
                    }
                }
                const bf16x8 mdf = pack8(md);
#pragma unroll
                for (int pt = 0; pt < 4; ++pt) {
                    const u32x2 lo = *(const LAS u32x2*)(xt + (pt * 16 + fr) * BP + (2 * pp) * 16 + fq * 4), hi = *(const LAS u32x2*)(xt + (pt * 16 + fr) * BP + (2 * pp + 1) * 16 + fq * 4);
                    const u32x4 av = {lo.x, lo.y, hi.x, hi.y};
                    yacc[pt] = mfma16(__builtin_bit_cast(bf16x8, av), mdf, yacc[pt]);
                }
            }
        }
#pragma unroll
        for (int pt = 0; pt < 4; ++pt)
#pragma unroll
            for (int ks = 0; ks < 4; ++ks) { const bf16x8 pf = *(const LAS bf16x8*)(prv + (pt * 16 + fr) * BP + ks * 32 + fq * 8); oacc[pt] = mfma16(pf, Cf[ks], oacc[pt]); }
        { const float el = __expf(cum_l); float ssq = 0.f;
#pragma unroll
          for (int pt = 0; pt < 4; ++pt) { const int col = h * 64 + pt * 16 + fq * 4;
              const u32x2 zz = *(const u32x2*)(prow + OFF_AZ + col); float z[4]; unpack4(zz, z); float o[4];
#pragma unroll
              for (int r = 0; r < 4; ++r) { float y = yacc[pt][r] + el * oacc[pt][r]; y *= silu_f(z[r]); o[r] = y; ssq += y * y; }
              u32x2 ov; ov.x = cvt_pk_bf16(o[0], o[1]); ov.y = cvt_pk_bf16(o[2], o[3]);
              *(u32x2*)(Y0 + row * BW + col) = ov; }
          ssq += __shfl_xor(ssq, 16); ssq += __shfl_xor(ssq, 32);
          if (fq == 0) ssqo[row * 16 + h] = ssq; }
        { const float et = __expf(total);
#pragma unroll
          for (int pt = 0; pt < 4; ++pt) { S[pt] = S[pt] * et;
#pragma unroll
              for (int ks = 0; ks < 4; ++ks) { const bf16x8 af = *(const LAS bf16x8*)(xwt + (pt * 16 + fr) * BP + ks * 32 + fq * 8), bf = *(const LAS bf16x8*)(Bt + (w * 16 + fr) * BP + ks * 32 + fq * 8);
                  S[pt] = mfma16(af, bf, S[pt]); } } }
        __syncthreads();
    }
}

__device__ __forceinline__ void rope_row16(const bf16_t* src, const float2* cs, LAS bf16_t* dst, int half, float scale) {
    const u32x4 a0 = *(const u32x4*)(src + half * 16), a1 = *(const u32x4*)(src + half * 16 + 8), b0 = *(const u32x4*)(src + 32 + half * 16), b1 = *(const u32x4*)(src + 32 + half * 16 + 8);
    float x1[16], x2[16], o1[16], o2[16];
    unpack8(a0, x1); unpack8(a1, x1 + 8); unpack8(b0, x2); unpack8(b1, x2 + 8);
#pragma unroll
    for (int j = 0; j < 16; j += 2) { const f32x4 c2 = *(const f32x4*)(cs + half * 16 + j);
        o1[j] = (x1[j] * c2[0] - x2[j] * c2[1]) * scale; o2[j] = (x2[j] * c2[0] + x1[j] * c2[1]) * scale;
        o1[j + 1] = (x1[j + 1] * c2[2] - x2[j + 1] * c2[3]) * scale; o2[j + 1] = (x2[j + 1] * c2[2] + x1[j + 1] * c2[3]) * scale; }
    *(LAS u32x4*)(dst + half * 16) = pack8u(o1); *(LAS u32x4*)(dst + half * 16 + 8) = pack8u(o1 + 8);
    *(LAS u32x4*)(dst + 32 + half * 16) = pack8u(o2); *(LAS u32x4*)(dst + 32 + half * 16 + 8) = pack8u(o2 + 8);
}

__device__ __forceinline__ void swa_item(const Params& p, int layer, int item, LAS unsigned char* lds) {
    const int tid = opaque_tid(), lane = tid & 63, w = __builtin_amdgcn_readfirstlane(tid >> 6), fr = lane & 15, fq = lane >> 4;
    const int b = item >> 6, nb = (item >> 2) & 15, kvh = item & 3;
    constexpr int KP = 72, VP = 264;
    LAS bf16_t* Ks = (LAS bf16_t*)lds;
    LAS bf16_t* Vt = Ks + 256 * KP;
    LAS bf16_t* Qs = Vt + 64 * VP + w * 32 * KP;
    const bf16_t* proj = (const bf16_t*)(p.ws + WS_PROJ);
    const float2* rope = (const float2*)(p.ws + WS_ROPE);
    bf16_t* Y1 = (bf16_t*)(p.ws + WS_Y) + (size_t)1 * MTOK * BW;
    __syncthreads();
    { const int key = tid >> 1, half = tid & 1, t = nb * 128 - 128 + key;
      if (t >= 0) {
          const size_t row = (size_t)b * SEQ + t;
          rope_row16(proj + row * NPAD + OFF_K + kvh * 64, rope + row * 32, Ks + key * KP, half, 1.f);
          const bf16_t* vr = proj + row * NPAD + OFF_V + kvh * 64 + half * 32;
#pragma unroll
          for (int q = 0; q < 4; ++q) { const u32x4 v = *(const u32x4*)(vr + q * 8);
#pragma unroll
              for (int j = 0; j < 8; ++j) Vt[(half * 32 + q * 8 + j) * VP + key] = (bf16_t)((j & 1) ? (v[j >> 1] >> 16) : (v[j >> 1] & 0xffffu)); }
      } else {
          const u32x4 z = {0u, 0u, 0u, 0u};
          *(LAS u32x4*)(Ks + key * KP + half * 16) = z; *(LAS u32x4*)(Ks + key * KP + half * 16 + 8) = z; *(LAS u32x4*)(Ks + key * KP + 32 + half * 16) = z; *(LAS u32x4*)(Ks + key * KP + 32 + half * 16 + 8) = z;
#pragma unroll
          for (int j = 0; j < 32; ++j) Vt[(half * 32 + j) * VP + key] = 0;
      } }
    __syncthreads();
    for (int uu = 0; uu < 2; ++uu) {
        const int u = w * 2 + uu, hh = u >> 2, qt = u & 3, hq = kvh * 4 + hh;
        { const int qr = lane >> 1, half = lane & 1; const size_t row = (size_t)b * SEQ + nb * 128 + qt * 32 + qr;
          rope_row16(proj + row * NPAD + OFF_Q + hq * 64, rope + row * 32, Qs + qr * KP, half, 0.125f); }
        bf16x8 Qf[2][2];
#pragma unroll
        for (int s = 0; s < 2; ++s)
#pragma unroll
            for (int ks = 0; ks < 2; ++ks) Qf[s][ks] = *(const LAS bf16x8*)(Qs + (s * 16 + fr) * KP + ks * 32 + fq * 8);
        f32x4 sc[10][2];
#pragma unroll
        for (int kt = 0; kt < 10; ++kt) {
            const bf16x8 k0 = *(const LAS bf16x8*)(Ks + (qt * 32 + kt * 16 + fr) * KP + fq * 8), k1 = *(const LAS bf16x8*)(Ks + (qt * 32 + kt * 16 + fr) * KP + 32 + fq * 8);
#pragma unroll
            for (int s = 0; s < 2; ++s) { f32x4 a = (f32x4){0.f, 0.f, 0.f, 0.f}; a = mfma16(k0, Qf[s][0], a); a = mfma16(k1, Qf[s][1], a); sc[kt][s] = a; }
        }
        const float sink = p.attn_sinks[layer * 16 + hq];
        float mx[2] = {-INFINITY, -INFINITY};
#pragma unroll
        for (int kt = 0; kt < 10; ++kt)
#pragma unroll
            for (int s = 0; s < 2; ++s)
#pragma unroll
                for (int r = 0; r < 4; ++r) { const int rel = 128 + s * 16 + fr - kt * 16 - fq * 4 - r, ki = qt * 32 + kt * 16 + fq * 4 + r;
                    const bool valid = (rel >= 0) && (rel < 128) && (nb > 0 || ki >= 128);
                    const float v = valid ? sc[kt][s][r] : -INFINITY; sc[kt][s][r] = v; mx[s] = fmaxf(mx[s], v); }
        float inv[2];
#pragma unroll
        for (int s = 0; s < 2; ++s) { mx[s] = fmaxf(mx[s], __shfl_xor(mx[s], 16)); mx[s] = fmaxf(mx[s], __shfl_xor(mx[s], 32)); mx[s] = fmaxf(mx[s], sink); }
        float sum[2] = {0.f, 0.f};
#pragma unroll
        for (int kt = 0; kt < 10; ++kt)
#pragma unroll
            for (int s = 0; s < 2; ++s)
#pragma unroll
                for (int r = 0; r < 4; ++r) { const float e = __expf(sc[kt][s][r] - mx[s]); sc[kt][s][r] = e; sum[s] += e; }
#pragma unroll
        for (int s = 0; s < 2; ++s) { sum[s] += __shfl_xor(sum[s], 16); sum[s] += __shfl_xor(sum[s], 32); sum[s] += __expf(sink - mx[s]); inv[s] = 1.f / sum[s]; }
        f32x4 oa[4][2];
#pragma unroll
        for (int d = 0; d < 4; ++d)
#pragma unroll
            for (int s = 0; s < 2; ++s) oa[d][s] = (f32x4){0.f, 0.f, 0.f, 0.f};
#pragma unroll
        for (int kk = 0; kk < 5; ++kk) {
            bf16x8 pf[2];
#pragma unroll
            for (int s = 0; s < 2; ++s) { float e8[8];
#pragma unroll
                for (int r = 0; r < 4; ++r) { e8[r] = sc[2 * kk][s][r]; e8[4 + r] = sc[2 * kk + 1][s][r]; }
                pf[s] = pack8(e8); }
#pragma unroll
            for (int d = 0; d < 4; ++d) {
                const u32x2 lo = *(const LAS u32x2*)(Vt + (d * 16 + fr) * VP + qt * 32 + (2 * kk) * 16 + fq * 4), hi = *(const LAS u32x2*)(Vt + (d * 16 + fr) * VP + qt * 32 + (2 * kk + 1) * 16 + fq * 4);
                const u32x4 vv = {lo.x, lo.y, hi.x, hi.y}; const bf16x8 vf = __builtin_bit_cast(bf16x8, vv);
#pragma unroll
                for (int s = 0; s < 2; ++s) oa[d][s] = mfma16(vf, pf[s], oa[d][s]);
            }
        }
#pragma unroll
        for (int s = 0; s < 2; ++s) { const size_t row = (size_t)b * SEQ + nb * 128 + qt * 32 + s * 16 + fr;
#pragma unroll
            for (int d = 0; d < 4; ++d) { const int col = hq * 64 + d * 16 + fq * 4;
                const u32x2 gg = *(const u32x2*)(proj + row * NPAD + OFF_BG + col); float gt[4]; unpack4(gg, gt); float o[4];
#pragma unroll
                for (int r = 0; r < 4; ++r) o[r] = oa[d][s][r] * inv[s] * silu_f(gt[r]);
                u32x2 ov; ov.x = cvt_pk_bf16(o[0], o[1]); ov.y = cvt_pk_bf16(o[2], o[3]);
                *(u32x2*)(Y1 + row * BW + col) = ov; } }
    }
}

__device__ __forceinline__ void sconv_item(const Params& p, int layer, int item) {
    const int tid = opaque_tid(), cgp = tid & 127, rg = tid >> 7, c0 = cgp * 8;
    const bf16_t* proj = (const bf16_t*)(p.ws + WS_PROJ);
    bf16_t* Y2 = (bf16_t*)(p.ws + WS_Y) + (size_t)2 * MTOK * BW;
    float wk[3][8];
#pragma unroll
    for (int k = 0; k < 3; ++k) { const f32x4 a = *(const f32x4*)(p.sconv_w + (size_t)(layer * 3 + k) * BW + c0), bq = *(const f32x4*)(p.sconv_w + (size_t)(layer * 3 + k) * BW + c0 + 4);
#pragma unroll
        for (int j = 0; j < 4; ++j) { wk[k][j] = a[j]; wk[k][4 + j] = bq[j]; } }
    const int r0 = item * 32 + rg * 8;
    float p2[8], p1[8];
#pragma unroll
    for (int j = 0; j < 8; ++j) { p2[j] = 0.f; p1[j] = 0.f; }
    const int t0 = r0 & (SEQ - 1);
    if (t0 >= 2) { const bf16_t* pr = proj + (size_t)(r0 - 2) * NPAD; float a[8], x[8]; unpack8(*(const u32x4*)(pr + OFF_CC + c0), a); unpack8(*(const u32x4*)(pr + OFF_CX + c0), x);
#pragma unroll
        for (int j = 0; j < 8; ++j) p2[j] = a[j] * x[j]; }
    if (t0 >= 1) { const bf16_t* pr = proj + (size_t)(r0 - 1) * NPAD; float a[8], x[8]; unpack8(*(const u32x4*)(pr + OFF_CC + c0), a); unpack8(*(const u32x4*)(pr + OFF_CX + c0), x);
#pragma unroll
        for (int j = 0; j < 8; ++j) p1[j] = a[j] * x[j]; }
#pragma unroll 2
    for (int i = 0; i < 8; ++i) {
        const size_t row = (size_t)(r0 + i); const bf16_t* pr = proj + row * NPAD;
        float bb[8], a[8], x[8], gg[8], o[8];
        unpack8(*(const u32x4*)(pr + OFF_CB + c0), bb); unpack8(*(const u32x4*)(pr + OFF_CC + c0), a); unpack8(*(const u32x4*)(pr + OFF_CX + c0), x); unpack8(*(const u32x4*)(pr + OFF_CG + c0), gg);
#pragma unroll
        for (int j = 0; j < 8; ++j) { const float pc = a[j] * x[j]; const float cv = wk[0][j] * p2[j] + wk[1][j] * p1[j] + wk[2][j] * pc; o[j] = bb[j] * cv * silu_f(gg[j]); p2[j] = p1[j]; p1[j] = pc; }
        *(u32x4*)(Y2 + row * BW + c0) = pack8u(o);
    }
}

__device__ __forceinline__ void lru_item(const Params& p, int layer, int item, LAS unsigned char* lds) {
    const int tid = opaque_tid(), lane = tid & 63, w = __builtin_amdgcn_readfirstlane(tid >> 6), fr = lane & 15, fq = lane >> 4;
    const int b = item >> 4, hb = item & 15;
    LAS bf16_t* Wt = (LAS bf16_t*)lds;
    LAS float* cwl = (LAS float*)(lds + 18432);
    LAS float* xsT = (LAS float*)(lds + 19712);
    LAS float* xch = (LAS float*)(lds + 54528);
    const bf16_t* proj = (const bf16_t*)(p.ws + WS_PROJ);
    bf16_t* Y3 = (bf16_t*)(p.ws + WS_Y) + (size_t)3 * MTOK * BW;
    __syncthreads();
    for (int i = tid; i < 2 * 64 * 64; i += NTHR) { const int mat = i >> 12, ii = (i >> 6) & 63, j = i & 63; const float* W = mat ? p.lru_w_x : p.lru_w_a;
        Wt[(mat * 64 + j) * 72 + ii] = f2bf(W[((size_t)(layer * 16 + hb) * 64 + ii) * 64 + j]); }
    for (int i = tid; i < 320; i += NTHR) { const int k = i >> 6, ch = i & 63; cwl[i] = k < 4 ? p.lru_conv_w[(size_t)(layer * 4 + k) * BW + hb * 64 + ch] : p.lru_conv_b[layer * BW + hb * 64 + ch]; }
    float ba[4], bx[4], sp8[4];
#pragma unroll
    for (int nt = 0; nt < 4; ++nt) { const int j = layer * BW + hb * 64 + nt * 16 + fr; ba[nt] = p.lru_b_a[j]; bx[nt] = p.lru_b_x[j];
        const float lam = p.lru_lambda[j]; const float nl = -lam; const float spv = (nl > 20.f) ? nl : log1pf(__expf(nl)); sp8[nt] = -8.f * spv; }
    __syncthreads();
    float Hround[4] = {0.f, 0.f, 0.f, 0.f};
    LAS float* xs = xsT + w * 16 * 68;
    for (int r = 0; r < 16; ++r) {
        const int ts = r * 128 + w * 16 + fr; const size_t row = (size_t)b * SEQ + ts; const bf16_t* prow = proj + row * NPAD;
        bf16x8 Af[2];
#pragma unroll
        for (int ks = 0; ks < 2; ++ks) { const int c0 = ks * 32 + fq * 8; float f[8];
            conv4_8<64>(prow + OFF_DX + hb * 64 + c0, ts, cwl + c0, f); Af[ks] = pack8(f);
            *(LAS f32x4*)(xs + fr * 68 + c0) = (f32x4){f[0], f[1], f[2], f[3]}; *(LAS f32x4*)(xs + fr * 68 + c0 + 4) = (f32x4){f[4], f[5], f[6], f[7]}; }
        float hl[4][4], pp[4][4];
#pragma unroll
        for (int nt = 0; nt < 4; ++nt) {
            f32x4 ga = (f32x4){0.f, 0.f, 0.f, 0.f}, gx = (f32x4){0.f, 0.f, 0.f, 0.f};
#pragma unroll
            for (int ks = 0; ks < 2; ++ks) { const bf16x8 wa = *(const LAS bf16x8*)(Wt + (nt * 16 + fr) * 72 + ks * 32 + fq * 8), wx = *(const LAS bf16x8*)(Wt + (64 + nt * 16 + fr) * 72 + ks * 32 + fq * 8);
                ga = mfma16(Af[ks], wa, ga); gx = mfma16(Af[ks], wx, gx); }
            float P = 1.f, H = 0.f;
#pragma unroll
            for (int rr = 0; rr < 4; ++rr) { const float xsv = xs[(fq * 4 + rr) * 68 + nt * 16 + fr];
                const float rgt = sigm_f(ga[rr] + ba[nt]), igt = sigm_f(gx[rr] + bx[nt]); const float la = sp8[nt] * rgt; const float a = __expf(la);
                const float uu = sqrtf(-expm1f(2.f * la)) * igt * xsv; H = a * H + uu; P = P * a; hl[nt][rr] = H; pp[nt][rr] = P; }
            const float P0 = __shfl(P, fr), H0 = __shfl(H, fr), P1 = __shfl(P, fr + 16), H1 = __shfl(H, fr + 16), P2 = __shfl(P, fr + 32), H2 = __shfl(H, fr + 32);
            float Pc = 1.f, Hc = 0.f;
            if (fq >= 1) { Pc = P0; Hc = H0; }
            if (fq >= 2) { Hc = P1 * Hc + H1; Pc *= P1; }
            if (fq >= 3) { Hc = P2 * Hc + H2; Pc *= P2; }
#pragma unroll
            for (int rr = 0; rr < 4; ++rr) { hl[nt][rr] += pp[nt][rr] * Hc; pp[nt][rr] *= Pc; }
            const float Pt = __shfl(pp[nt][3], 48 + fr), Ht = __shfl(hl[nt][3], 48 + fr);
            if (fq == 0) { xch[((r & 1) * 8 + w) * 128 + nt * 16 + fr] = Pt; xch[((r & 1) * 8 + w) * 128 + 64 + nt * 16 + fr] = Ht; }
        }
        __syncthreads();
        float Hin[4];
#pragma unroll
        for (int nt = 0; nt < 4; ++nt) { float H = Hround[nt], hin = 0.f;
#pragma unroll
            for (int w2 = 0; w2 < 8; ++w2) { const float Pw = xch[((r & 1) * 8 + w2) * 128 + nt * 16 + fr], Hw = xch[((r & 1) * 8 + w2) * 128 + 64 + nt * 16 + fr]; if (w2 == w) hin = H; H = Pw * H + Hw; }
            Hround[nt] = H; Hin[nt] = hin; }
#pragma unroll
        for (int nt = 0; nt < 4; ++nt)
#pragma unroll
            for (int rr = 0; rr < 4; ++rr) { const size_t orow = (size_t)b * SEQ + r * 128 + w * 16 + fq * 4 + rr; const int col = hb * 64 + nt * 16 + fr;
                const float hv = hl[nt][rr] + pp[nt][rr] * Hin[nt]; const float gt = bf2f(proj[orow * NPAD + OFF_DG + col]);
                Y3[orow * BW + col] = f2bf(hv * silu_f(gt)); }
    }
}

__device__ __forceinline__ int first_item(int lo) { const int c = blockIdx.x, G = gridDim.x, d = lo - c; return d <= 0 ? c : c + ((d + G - 1) / G) * G; }
__device__ __forceinline__ void phase_mixers(const Params& p, int layer, LAS unsigned char* lds) {
    const int G = gridDim.x;
    if (PHM & 8) { for (int it = first_item(0); it < 128; it += G) ssd_item(p, layer, it, lds); }
    if (PHM & 16) { for (int it = first_item(128); it < 256; it += G) lru_item(p, layer, it - 128, lds); }
    if (PHM & 32) { for (int it = first_item(256); it < 768; it += G) swa_item(p, layer, it - 256, lds); }
    if (PHM & 64) { for (int it = first_item(768); it < 1280; it += G) sconv_item(p, layer, it - 768); }
}

__global__ void __launch_bounds__(NTHR, 2) hybrid_fwd(Params p) {
    extern __shared__ __attribute__((aligned(16))) unsigned char lds_raw[];
    LAS unsigned char* lds = (LAS unsigned char*)lds_raw;
    cg::grid_group grid = cg::this_grid();
    const int G = gridDim.x, c = blockIdx.x;
    if (PHM & 1) phase_prologue(p, lds);
    grid.sync();
    if (PHM & 2) phase_h0(p);
    grid.sync();
#pragma unroll 1
    for (int layer = 0; layer < 2; ++layer) {
        if (PHM & 4) { pg8::Gemm g; g.A = (const bf16_t*)(p.ws + WS_H); g.Bt = (const bf16_t*)(p.ws + WS_WIN) + (size_t)layer * NPAD * 2048; g.M = MTOK; g.N = NPAD; g.K = 2048;
          pg8::StaticOrder S; S.init(MTOK, NPAD, G, c);
          pg8::EpiProj E; E.O = (bf16_t*)(p.ws + WS_PROJ);
          pg8::gemm_phase<pg8::EpiProj, pg8::StaticOrder, true, true>(lds, g, S, E); }
        grid.sync();
        phase_mixers(p, layer, lds);
        grid.sync();
        if (PHM & 128) { pg8::Gemm g; g.A = (const bf16_t*)(p.ws + WS_Y); g.Bt = (const bf16_t*)(p.ws + WS_WB) + (size_t)layer * 8192 * 1024; g.M = 4 * MTOK; g.N = 8192; g.K = 1024;
          pg8::MergeOrder S; S.base.init(MTOK, DM, G, c);
          pg8::EpiMerge E; E.proj = (const bf16_t*)(p.ws + WS_PROJ); E.bgate = p.b_gate + (size_t)layer * 4 * DM; E.ssq = (const float*)(p.ws + WS_SSQ); E.mf = (float*)(p.ws + WS_MF); E.mb = (bf16_t*)(p.ws + WS_MB);
          pg8::gemm_phase<pg8::EpiMerge, pg8::MergeOrder, true, true>(lds, g, S, E); }
        grid.sync();
        if (PHM & 256) { pg8::Gemm g; g.A = (const bf16_t*)(p.ws + WS_MB); g.Bt = (const bf16_t*)(p.ws + WS_WO) + (size_t)layer * 2048 * 2048; g.M = MTOK; g.N = DM; g.K = 2048;
          pg8::StaticOrder S; S.init(MTOK, DM, G, c);
          pg8::EpiOut E; E.xin = layer == 0 ? p.x : p.out; E.gate = (const float*)(p.ws + WS_ADA) + (size_t)layer * 8 * 6144 + 4096; E.R = (float*)(p.ws + WS_MF);
          pg8::gemm_phase<pg8::EpiOut, pg8::StaticOrder, true, true>(lds, g, S, E); }
        grid.sync();
        if (PHM & 512) phase_ln(p, layer);
        if (layer == 0) grid.sync();
    }
}

extern "C" void kernel_launch(void* const* d_in, const int* in_sizes, int n_in, void* d_out, int out_size, void* d_ws, size_t ws_size, hipStream_t stream) {
    static int grid = 0;
    if (grid == 0) {
        if (n_in != 26 || out_size != MTOK * DM || ws_size < WS_END) { fprintf(stderr, "kernel_launch: unexpected shapes (n_in %d, out %d, ws %zu)\n", n_in, out_size, ws_size); grid = -1; return; }
        int dev = 0, cus = 0, per_cu = 0;
        (void)hipGetDevice(&dev);
        (void)hipDeviceGetAttribute(&cus, hipDeviceAttributeMultiprocessorCount, dev);
        if (hipFuncSetAttribute((const void*)hybrid_fwd, hipFuncAttributeMaxDynamicSharedMemorySize, LDS_BYTES) != hipSuccess) { fprintf(stderr, "kernel_launch: hipFuncSetAttribute failed\n"); grid = -1; return; }
        if (hipOccupancyMaxActiveBlocksPerMultiprocessor(&per_cu, (const void*)hybrid_fwd, NTHR, LDS_BYTES) != hipSuccess || per_cu < 1) { fprintf(stderr, "kernel_launch: occupancy query failed (%d)\n", per_cu); per_cu = 1; }
        (void)hipGetLastError();
        grid = cus * 1;
    }
    if (grid < 0) return;
    Params p{};
    p.x = (const float*)d_in[0]; p.c = (const float*)d_in[1]; p.pos = (const int*)d_in[2]; p.w_ada = (const float*)d_in[3]; p.b_ada = (const float*)d_in[4];
    p.w_in = (const float*)d_in[5]; p.b_gate = (const float*)d_in[6]; p.ssd_conv_w = (const float*)d_in[7]; p.ssd_conv_b = (const float*)d_in[8];
    p.ssd_dt_bias = (const float*)d_in[9]; p.ssd_a_log = (const float*)d_in[10]; p.ssd_d = (const float*)d_in[11]; p.ssd_norm_w = (const float*)d_in[12];
    p.attn_sinks = (const float*)d_in[13]; p.sconv_w = (const float*)d_in[14]; p.lru_conv_w = (const float*)d_in[15]; p.lru_conv_b = (const float*)d_in[16];
    p.lru_w_a = (const float*)d_in[17]; p.lru_b_a = (const float*)d_in[18]; p.lru_w_x = (const float*)d_in[19]; p.lru_b_x = (const float*)d_in[20];
    p.lru_lambda = (const float*)d_in[21]; p.w_branch = (const float*)d_in[22]; p.w_out = (const float*)d_in[23]; p.ln_w = (const float*)d_in[24]; p.ln_b = (const float*)d_in[25];
    p.out = (float*)d_out; p.ws = (unsigned char*)d_ws;
    void* args[] = {&p};
    hipError_t e = hipLaunchCooperativeKernel((const void*)hybrid_fwd, dim3(grid), dim3(NTHR), args, LDS_BYTES, stream);
    if (e != hipSuccess) fprintf(stderr, "kernel_launch: cooperative launch failed: %s (grid %d)\n", hipGetErrorString(e), grid);
}
```
